# Optimizing an MI355X kernel written in HIP

```python
import jax, jax.numpy as jnp
from jax import lax
import numpy as np

D_MODEL = 1024
BATCH = 2
SEQ = 8192
DEPTH = 2

HEAD_DIM = 64
BLOCK = 128
N_MEM = 256
BRANCH_WIDTH = 256
N_BRANCH = 4
POOL_WINDOWS = (2, 4, 8, 16)
POOL_GROUPS = 4
POOL_GDIM = BRANCH_WIDTH // POOL_GROUPS
DSA_HEADS = 4
DSA_LATENT = 128
IDX_HEADS = 8
IDX_DIM = 32
DSA_TOPK_MAX = 256
SB_HEADS = 4
SWA_HEADS = 4
SWA_KV_HEADS = 2
SWA_WINDOW = 128
MEM_HEADS = 4
D_FF = ((8 * D_MODEL // 3 + 255) // 256) * 256
RMS_EPS = 1e-6

SPLIT_SIZES = (
    BRANCH_WIDTH,
    DSA_HEADS * HEAD_DIM,
    DSA_LATENT,
    IDX_HEADS * IDX_DIM,
    IDX_DIM,
    IDX_HEADS,
    SB_HEADS * HEAD_DIM,
    SB_HEADS * HEAD_DIM,
    SB_HEADS * HEAD_DIM,
    SWA_HEADS * HEAD_DIM,
    SWA_KV_HEADS * HEAD_DIM,
    SWA_KV_HEADS * HEAD_DIM,
    N_BRANCH * D_MODEL,
)
D_IN = sum(SPLIT_SIZES)

kernel_name = "hybrid_gated_pool_dsa_stickbreak_swa"


def _split_points():
    pts, acc = [], 0
    for s in SPLIT_SIZES[:-1]:
        acc += s
        pts.append(acc)
    return pts


def rmsnorm(x, g):
    x32 = x.astype(jnp.float32)
    y = x32 * lax.rsqrt(jnp.mean(x32 * x32, axis=-1, keepdims=True) + RMS_EPS)
    return (y * g).astype(x.dtype)


def swiglu(h, w_up, w_down):
    gate, up = jnp.split(h @ w_up, 2, axis=-1)
    return (jax.nn.silu(gate) * up) @ w_down


def _blocks(a, nb):
    return a.reshape(a.shape[0], nb, BLOCK, *a.shape[2:]).swapaxes(0, 1)


def _unblocks(a):
    a = a.swapaxes(0, 1)
    return a.reshape(a.shape[0], a.shape[1] * a.shape[2], *a.shape[3:])


def _trailing_mean_minus_self(u, w):
    S = u.shape[1]
    c = jnp.cumsum(u, axis=1)
    c_prev = jnp.pad(c, ((0, 0), (w, 0), (0, 0)))[:, :S]
    cnt = jnp.minimum(jnp.arange(1, S + 1), w).astype(u.dtype)[None, :, None]
    return (c - c_prev) / cnt - u


def pool_mixer(u, pool_w, pool_scale):
    B, S, _ = u.shape
    ug = u.astype(jnp.float32).reshape(B, S, POOL_GROUPS, POOL_GDIM)
    pooled = jnp.stack([_trailing_mean_minus_self(ug[:, :, g], w)
                        for g, w in enumerate(POOL_WINDOWS)], axis=2)
    mixed = jnp.einsum('bsgc,gcd->bsgd', pooled.astype(u.dtype), pool_w)
    return mixed.reshape(B, S, BRANCH_WIDTH) * pool_scale


def dsa_mixer(q, c_kv, idx_q, idx_k, idx_w, kv_norm, w_uk, w_uv):
    B, S = q.shape[:2]
    nb = S // BLOCK
    topk = min(DSA_TOPK_MAX, S // 4)
    c = rmsnorm(c_kv, kv_norm)
    q_lat = jnp.einsum('bshd,rhd->bshr', q, w_uk)
    ik = idx_k.astype(jnp.float32)
    key_pos = jnp.arange(S)

    def one_block(args):
        n, qb, iqb, iwb = args
        qpos = n * BLOCK + jnp.arange(BLOCK)
        causal = key_pos[None, :] <= qpos[:, None]
        logits = jnp.einsum('bqhd,bsd->bqhs', iqb.astype(jnp.float32), ik) * IDX_DIM ** -0.5
        score = jnp.einsum('bqh,bqhs->bqs', iwb.astype(jnp.float32), jax.nn.relu(logits))
        score = jnp.where(causal[None], score, -jnp.inf)
        _, idx = lax.top_k(score, topk)
        valid = idx <= qpos[None, :, None]
        c_sel = jax.vmap(lambda cb, ib: cb[ib])(c, idx)
        s = jnp.einsum('bqhr,bqkr->bqhk', qb.astype(jnp.float32),
                       c_sel.astype(jnp.float32)) * HEAD_DIM ** -0.5
        s = jnp.where(valid[:, :, None, :], s, -jnp.inf)
        p = jax.nn.softmax(s, axis=-1)
        return jnp.einsum('bqhk,bqkr->bqhr', p.astype(c.dtype), c_sel)

    o_lat = lax.map(one_block, (jnp.arange(nb), _blocks(q_lat, nb),
                                _blocks(idx_q, nb), _blocks(idx_w, nb)))
    o = jnp.einsum('bshr,rhd->bshd', _unblocks(o_lat), w_uv)
    return o.reshape(B, S, DSA_HEADS * HEAD_DIM)


def stick_breaking_mixer(q, k, v):
    B, S, H, dh = q.shape
    nb = S // BLOCK
    kf = k.astype(jnp.float32)
    key_pos = jnp.arange(S)

    def one_block(args):
        n, qb = args
        qpos = n * BLOCK + jnp.arange(BLOCK)
        strict = (key_pos[None, :] < qpos[:, None])[None, None]
        z = jnp.einsum('bqhd,bshd->bhqs', qb.astype(jnp.float32), kf) * dh ** -0.5
        log_1m_beta = jnp.where(strict, jax.nn.log_sigmoid(-z), 0.0)
        between = lax.cumsum(log_1m_beta, axis=3, reverse=True) - log_1m_beta
        a = jnp.where(strict, jnp.exp(jax.nn.log_sigmoid(z) + between), 0.0)
        return jnp.einsum('bhqs,bshd->bqhd', a.astype(v.dtype), v)

    o = lax.map(one_block, (jnp.arange(nb), _blocks(q, nb)))
    return _unblocks(o).reshape(B, S, H * dh)


def swa_sink_mixer(q, k, v, sinks):
    B, S, HQ, dh = q.shape
    HKV = k.shape[2]
    G = HQ // HKV
    nb = S // BLOCK
    qb = q.reshape(B, nb, BLOCK, HKV, G, dh)

    def band(a):
        ab = a.reshape(B, nb, BLOCK, HKV, dh)
        prev = jnp.pad(ab, ((0, 0), (1, 0), (0, 0), (0, 0), (0, 0)))[:, :nb]
        return jnp.concatenate([prev, ab], axis=2)

    kb, vb = band(k), band(v)
    s = jnp.einsum('bnqkgd,bnjkd->bnkgqj', qb.astype(jnp.float32),
                   kb.astype(jnp.float32)) * dh ** -0.5
    kj = jnp.arange(2 * BLOCK)[None, :]
    rel = (jnp.arange(BLOCK)[:, None] + BLOCK) - kj
    in_window = (rel >= 0) & (rel < SWA_WINDOW)
    key_ok = (jnp.arange(nb)[:, None] * BLOCK - BLOCK + kj) >= 0
    mask = in_window[None] & key_ok[:, None, :]
    s = jnp.where(mask[None, :, None, None], s, -jnp.inf)
    sink = jnp.broadcast_to(sinks.astype(jnp.float32).reshape(HKV, G)[None, None, :, :, None, None],
                            s.shape[:-1] + (1,))
    p = jax.nn.softmax(jnp.concatenate([s, sink], axis=-1), axis=-1)[..., :-1]
    o = jnp.einsum('bnkgqj,bnjkd->bnqkgd', p.astype(v.dtype), vb)
    return o.reshape(B, S, HQ * dh)


def hybrid_mixer(h, w_in, pool_w, pool_scale, dsa_kv_norm, dsa_w_uk, dsa_w_uv,
                 swa_sinks, w_branch, w_out):
    B, S, _ = h.shape
    (u_pool, dsa_q, dsa_ckv, idx_q, idx_k, idx_w, sb_q, sb_k, sb_v,
     swa_q, swa_k, swa_v, gate_logits) = jnp.split(h @ w_in, _split_points(), axis=-1)
    o_a = pool_mixer(u_pool, pool_w, pool_scale)
    o_b = dsa_mixer(dsa_q.reshape(B, S, DSA_HEADS, HEAD_DIM), dsa_ckv,
                    idx_q.reshape(B, S, IDX_HEADS, IDX_DIM), idx_k,
                    idx_w * IDX_HEADS ** -0.5, dsa_kv_norm, dsa_w_uk, dsa_w_uv)
    o_c = stick_breaking_mixer(sb_q.reshape(B, S, SB_HEADS, HEAD_DIM),
                               sb_k.reshape(B, S, SB_HEADS, HEAD_DIM),
                               sb_v.reshape(B, S, SB_HEADS, HEAD_DIM))
    o_d = swa_sink_mixer(swa_q.reshape(B, S, SWA_HEADS, HEAD_DIM),
                         swa_k.reshape(B, S, SWA_KV_HEADS, HEAD_DIM),
                         swa_v.reshape(B, S, SWA_KV_HEADS, HEAD_DIM), swa_sinks)
    branches = jnp.stack([o_a, o_b, o_c, o_d], axis=2)
    y = jnp.einsum('bsic,icd->bsid', branches, w_branch)
    gates = jax.nn.sigmoid(gate_logits.reshape(B, S, N_BRANCH, D_MODEL))
    merged = jnp.sum(gates * y, axis=2)
    return merged @ w_out


def memory_cross_attention(h, mem_n, w_q, w_kv, w_o):
    B, S, _ = h.shape
    M = mem_n.shape[1]
    q = (h @ w_q).reshape(B, S, MEM_HEADS, HEAD_DIM)
    k, v = jnp.split(mem_n @ w_kv, 2, axis=-1)
    k = k.reshape(B, M, MEM_HEADS, HEAD_DIM)
    v = v.reshape(B, M, MEM_HEADS, HEAD_DIM)
    s = jnp.einsum('bshd,bmhd->bhsm', q.astype(jnp.float32), k.astype(jnp.float32)) * HEAD_DIM ** -0.5
    p = jax.nn.softmax(s, axis=-1)
    o = jnp.einsum('bhsm,bmhd->bshd', p.astype(v.dtype), v)
    return o.reshape(B, S, MEM_HEADS * HEAD_DIM) @ w_o


def setup_inputs(seed: int = 0) -> dict:
    key = jax.random.key(seed)
    ks = iter(jax.random.split(key, 40))

    def nrm(shape, scale):
        return jax.random.normal(next(ks), shape, jnp.float32) * scale

    def gain(shape):
        return 1.0 + nrm(shape, 0.05)

    L, D, F = DEPTH, D_MODEL, D_FF
    return {
        "x": nrm((BATCH, SEQ, D), 1.0),
        "mem": nrm((BATCH, N_MEM, D), 1.0),
        "ffn1_pre": gain((L, D)),
        "ffn1_w_up": nrm((L, D, 2 * F), D ** -0.5),
        "ffn1_w_down": nrm((L, F, D), F ** -0.5),
        "ffn1_post": gain((L, D)),
        "mix_pre": gain((L, D)),
        "w_in": nrm((L, D, D_IN), D ** -0.5),
        "pool_w": nrm((L, POOL_GROUPS, POOL_GDIM, POOL_GDIM), POOL_GDIM ** -0.5),
        "pool_scale": 1.0 + nrm((L, BRANCH_WIDTH), 0.1),
        "dsa_kv_norm": gain((L, DSA_LATENT)),
        "dsa_w_uk": nrm((L, DSA_LATENT, DSA_HEADS, HEAD_DIM), HEAD_DIM ** -0.5),
        "dsa_w_uv": nrm((L, DSA_LATENT, DSA_HEADS, HEAD_DIM), DSA_LATENT ** -0.5),
        "swa_sinks": nrm((L, SWA_HEADS), 0.5),
        "w_branch": nrm((L, N_BRANCH, BRANCH_WIDTH, D), BRANCH_WIDTH ** -0.5),
        "w_out": nrm((L, D, D), D ** -0.5),
        "mix_post": gain((L, D)),
        "xattn_pre": gain((L, D)),
        "mem_norm": gain((L, D)),
        "xattn_w_q": nrm((L, D, MEM_HEADS * HEAD_DIM), D ** -0.5),
        "xattn_w_kv": nrm((L, D, 2 * MEM_HEADS * HEAD_DIM), D ** -0.5),
        "xattn_w_o": nrm((L, MEM_HEADS * HEAD_DIM, D), (MEM_HEADS * HEAD_DIM) ** -0.5),
        "xattn_post": gain((L, D)),
        "ffn2_pre": gain((L, D)),
        "ffn2_w_up": nrm((L, D, 2 * F), D ** -0.5),
        "ffn2_w_down": nrm((L, F, D), F ** -0.5),
        "ffn2_post": gain((L, D)),
    }


def reference(x, mem, ffn1_pre, ffn1_w_up, ffn1_w_down, ffn1_post,
              mix_pre, w_in, pool_w, pool_scale, dsa_kv_norm, dsa_w_uk, dsa_w_uv,
              swa_sinks, w_branch, w_out, mix_post,
              xattn_pre, mem_norm, xattn_w_q, xattn_w_kv, xattn_w_o, xattn_post,
              ffn2_pre, ffn2_w_up, ffn2_w_down, ffn2_post):
    for l in range(DEPTH):
        x = x + 0.5 * rmsnorm(swiglu(rmsnorm(x, ffn1_pre[l]), ffn1_w_up[l], ffn1_w_down[l]),
                              ffn1_post[l])
        m = hybrid_mixer(rmsnorm(x, mix_pre[l]), w_in[l], pool_w[l], pool_scale[l],
                         dsa_kv_norm[l], dsa_w_uk[l], dsa_w_uv[l], swa_sinks[l],
                         w_branch[l], w_out[l])
        x = x + rmsnorm(m, mix_post[l])
        c = memory_cross_attention(rmsnorm(x, xattn_pre[l]), rmsnorm(mem, mem_norm[l]),
                                   xattn_w_q[l], xattn_w_kv[l], xattn_w_o[l])
        x = x + rmsnorm(c, xattn_post[l])
        x = x + 0.5 * rmsnorm(swiglu(rmsnorm(x, ffn2_pre[l]), ffn2_w_up[l], ffn2_w_down[l]),
                              ffn2_post[l])
    return x
```

```cpp
#include <hip/hip_runtime.h>
#include <cstdio>
#include <cstdint>
#ifndef ONE_LAUNCH
#define ONE_LAUNCH 0
#endif
#if ONE_LAUNCH
#include <hip/hip_cooperative_groups.h>
namespace cg = cooperative_groups;
#endif

namespace pg8 {
#define PG8_LAS __attribute__((address_space(3)))
typedef _Float16 h16;
typedef short s16x8 __attribute__((ext_vector_type(8)));
typedef _Float16 h16x8 __attribute__((ext_vector_type(8)));
typedef _Float16 h16x4 __attribute__((ext_vector_type(4)));
typedef _Float16 h16x2 __attribute__((ext_vector_type(2)));
typedef float f32x4 __attribute__((ext_vector_type(4)));
typedef float f32x2 __attribute__((ext_vector_type(2)));
typedef unsigned u32x4 __attribute__((ext_vector_type(4)));
typedef unsigned u32x2 __attribute__((ext_vector_type(2)));
constexpr int BM = 256, BK = 64, HALF = 128, HTB = HALF * BK * 2  , STAGE_BYTES = 8 * HTB, NXCD = 8, WGM = 8;

__host__ __device__ __forceinline__ int lds_byte(int r, int c) { const int st = (r >> 4) * 2 + (c >> 5), rr = r & 15, cc = c & 31, ob = rr * 64 + cc * 2; return st * 1024 + (ob ^ (((ob >> 9) & 1) << 5)); }
__host__ __device__ __forceinline__ void stage_rc(int b, int& R, int& C) { const int st = b / 1024, sb = b % 1024, swz = sb ^ (((sb >> 9) & 1) << 5); R = (st >> 1) * 16 + swz / 64; C = (st & 1) * 32 + (swz % 64) / 2; }
__host__ __device__ __forceinline__ int perm32(int rho) { const int n = rho >> 4, i = rho & 15; return 8 * (i >> 2) + 4 * n + (i & 3); }

struct Unit { int pm, pn; };
struct Gemm { const h16* A; const h16* Bt; int lda, ldb, K, agrp, astep, pad; };

struct StaticOrder {
    int nM, nN, nwg, G, c;
    __host__ __device__ void init(int M, int N, int G_, int c_) { nM = M / BM; nN = N / BM; nwg = nM * nN; G = G_; c = c_; }
    __host__ __device__ bool next(int i, Unit& u) const {
        const long L = (long)i * G + c; if (L >= nwg) return false;
        int wgid = (int)L; { const int q = nwg / NXCD, r = nwg % NXCD, xcd = wgid % NXCD, off = wgid / NXCD; wgid = (xcd < r ? xcd * (q + 1) : r * (q + 1) + (xcd - r) * q) + off; }
        const int nig = WGM * nN, gid = wgid / nig, fm = gid * WGM, gsz = (nM - fm) < WGM ? (nM - fm) : WGM;
        u.pm = fm + ((wgid % nig) % gsz); u.pn = (wgid % nig) / gsz; return true;
    }
    __device__ __forceinline__ void a_ready(const Unit&) const {}
    __device__ __forceinline__ void done(const Unit&) const {}
};

__device__ __forceinline__ unsigned pk_h2(float lo, float hi) { h16x2 v = {(h16)lo, (h16)hi}; return __builtin_bit_cast(unsigned, v); }


struct EpiF16 {
    static constexpr bool PERM = true, AFTER_DRAIN = false;
    h16* O; float* css; int ldc, gsz, gb0, gb1, gb2, css_pn;
    __device__ __forceinline__ void operator()(const f32x4 (&acc)[2][2][4][2], const Unit& u, int wr, int wc, int fr, int fq) const {
        const int grp = u.pn / gsz; const int colb = (grp == 0 ? gb0 : grp == 1 ? gb1 : gb2) + (u.pn - grp * gsz) * BM;
        const int row0 = u.pm * BM + wr * 64 + fr, col0 = colb + wc * 32 + 8 * fq;
#pragma unroll
        for (int ai = 0; ai < 2; ++ai)
#pragma unroll
            for (int m = 0; m < 4; ++m) { h16* rowp = O + (size_t)(row0 + ai * HALF + m * 16) * ldc + col0;
#pragma unroll
                for (int bj = 0; bj < 2; ++bj) { const f32x4 v0 = acc[ai][bj][m][0], v1 = acc[ai][bj][m][1];
                    u32x4 w; w.x = pk_h2(v0[0], v0[1]); w.y = pk_h2(v0[2], v0[3]); w.z = pk_h2(v1[0], v1[1]); w.w = pk_h2(v1[2], v1[3]);
                    *(u32x4*)(rowp + bj * HALF) = w; } }
        if (css != nullptr && u.pn == css_pn) {
#pragma unroll
            for (int ai = 0; ai < 2; ++ai)
#pragma unroll
                for (int m = 0; m < 4; ++m) { const f32x4 v0 = acc[ai][0][m][0], v1 = acc[ai][0][m][1];
                    float s = (v0[0] * v0[0] + v0[1] * v0[1]) + (v0[2] * v0[2] + v0[3] * v0[3]) + (v1[0] * v1[0] + v1[1] * v1[1]) + (v1[2] * v1[2] + v1[3] * v1[3]);
                    s += __shfl_xor(s, 16); s += __shfl_xor(s, 32);
                    if (fq == 0) atomicAdd(css + (row0 + ai * HALF + m * 16), s); }
        }
    }
};
struct EpiSwiglu {
    static constexpr bool PERM = true, AFTER_DRAIN = false;
    h16* H; int ldc;
    __device__ __forceinline__ void operator()(const f32x4 (&acc)[2][2][4][2], const Unit& u, int wr, int wc, int fr, int fq) const {
        const int row0 = u.pm * BM + wr * 64 + fr, col0 = u.pn * HALF + wc * 32 + 8 * fq;
#pragma unroll
        for (int ai = 0; ai < 2; ++ai)
#pragma unroll
            for (int m = 0; m < 4; ++m) { h16* rowp = H + (size_t)(row0 + ai * HALF + m * 16) * ldc + col0;
                float r[8];
#pragma unroll
                for (int n = 0; n < 2; ++n)
#pragma unroll
                    for (int e = 0; e < 4; ++e) { const float gte = acc[ai][0][m][n][e], up = acc[ai][1][m][n][e];
                        const float sg = __builtin_amdgcn_rcpf(1.0f + __builtin_amdgcn_exp2f(gte * -1.4426950408889634f));
                        r[n * 4 + e] = gte * sg * up; }
                u32x4 w; w.x = pk_h2(r[0], r[1]); w.y = pk_h2(r[2], r[3]); w.z = pk_h2(r[4], r[5]); w.w = pk_h2(r[6], r[7]);
                *(u32x4*)rowp = w; }
    }
};
struct EpiGate {
    static constexpr bool PERM = false, AFTER_DRAIN = false;
    const h16* Y; h16* MG;
    __device__ __forceinline__ void operator()(const f32x4 (&acc)[2][2][4][2], const Unit& u, int wr, int wc, int fr, int fq) const {
        const int row0 = u.pm * BM + wr * 64 + fr, d0 = u.pn * 64 + wc * 16 + 4 * fq;
#pragma unroll
        for (int ai = 0; ai < 2; ++ai)
#pragma unroll
            for (int m = 0; m < 4; ++m) { const size_t row = (size_t)(row0 + ai * HALF + m * 16);
                const h16* yp = Y + row * 4096 + d0;
                float r[4] = {0.f, 0.f, 0.f, 0.f};
#pragma unroll
                for (int i = 0; i < 4; ++i) { const h16x4 yv = *(const h16x4*)(yp + i * 1024); const f32x4 gv = acc[ai][i & 1][m][i >> 1];
#pragma unroll
                    for (int e = 0; e < 4; ++e) { const float sg = __builtin_amdgcn_rcpf(1.0f + __builtin_amdgcn_exp2f(gv[e] * -1.4426950408889634f)); r[e] += sg * (float)yv[e]; } }
                u32x2 w; w.x = pk_h2(r[0], r[1]); w.y = pk_h2(r[2], r[3]);
                *(u32x2*)(MG + row * 1024 + d0) = w; }
    }
};

#define PG8_UA(u) ((const char*)g.A + (size_t)(u).pm * tstepA + (size_t)(((u).pn / g.agrp) * g.astep) * 2)
#define PG8_UB(u) ((const char*)g.Bt + (size_t)(u).pn * tstepB)
template <class Epi, class Sched, bool ALIGN_EPI = false, bool SP2 = false>
__device__ __forceinline__ void gemm_phase(PG8_LAS unsigned char* lds, const Gemm g, const Sched& S, const Epi& E) {
    const int tid = threadIdx.x, wid = __builtin_amdgcn_readfirstlane(tid >> 6), lane = tid & 63, wr = wid >> 2, wc = wid & 3, fr = lane & 15, fq = lane >> 4;
    const int nt = g.K / BK;
    unsigned voffA[2], voffB[2];
#pragma unroll
    for (int i = 0; i < 2; ++i) { int R, C; stage_rc(tid * 16 + i * 8192, R, C); const int Rb = Epi::PERM ? ((R & ~31) + perm32(R & 31)) : R;
        voffA[i] = (unsigned)(R * g.lda + C) * 2u; voffB[i] = (unsigned)(Rb * g.ldb + C) * 2u; }
    const size_t kstep = (size_t)(BK * 2);
    const size_t hstepA = (size_t)HALF * g.lda * 2, hstepB = (size_t)HALF * g.ldb * 2;
    const size_t tstepA = 2 * hstepA, tstepB = 2 * hstepB;
    const unsigned ldsw = (unsigned)wid * 1024u;
    const int aoff = lds_byte(wr * 64 + fr, fq * 8), boff = lds_byte(wc * 32 + fr, fq * 8);
#define PG8_SA(b, h) (((b) * 2 + (h)) * HTB)
#define PG8_SB(b, h) ((4 + (b) * 2 + (h)) * HTB)
#define PG8_STAGE(bufoff, gbase, voff) do { _Pragma("unroll") for (int _i = 0; _i < 2; ++_i) \
        __builtin_amdgcn_global_load_lds((const unsigned*)((const char*)(gbase) + (voff)[_i]), (PG8_LAS unsigned*)(lds + (bufoff) + ldsw + _i * 8192), 16, 0, 0); } while (0)
#define PG8_LDA(dst, b, h) do { _Pragma("unroll") for (int m = 0; m < 4; ++m) _Pragma("unroll") for (int k = 0; k < 2; ++k) dst[m][k] = *(const PG8_LAS s16x8*)(lds + PG8_SA(b, h) + aoff + m * 2048 + k * 1024); } while (0)
#define PG8_LDB(dst, b, h) do { _Pragma("unroll") for (int n = 0; n < 2; ++n) _Pragma("unroll") for (int k = 0; k < 2; ++k) dst[n][k] = *(const PG8_LAS s16x8*)(lds + PG8_SB(b, h) + boff + n * 2048 + k * 1024); } while (0)
#define PG8_MMA(ai, bj, At, Bt) do { __builtin_amdgcn_s_setprio(1); _Pragma("unroll") for (int m = 0; m < 4; ++m) _Pragma("unroll") for (int n = 0; n < 2; ++n) _Pragma("unroll") for (int k = 0; k < 2; ++k) \
        acc[ai][bj][m][n] = __builtin_amdgcn_mfma_f32_16x16x32_f16(__builtin_bit_cast(h16x8, Bt[n][k]), __builtin_bit_cast(h16x8, At[m][k]), acc[ai][bj][m][n], 0, 0, 0); __builtin_amdgcn_s_setprio(0); } while (0)
#define PG8_WAIT_V(n) asm volatile("s_waitcnt vmcnt(" #n ")" ::: "memory")
#define PG8_WAIT_L(n) asm volatile("s_waitcnt lgkmcnt(" #n ")" ::: "memory")
#define PG8_BAR __builtin_amdgcn_s_barrier()
#define PG8_SCHED __builtin_amdgcn_sched_barrier(0)
    Unit cur, nxt; int ui = 0;
    if (!S.next(0, cur)) return;
    f32x4 acc[2][2][4][2];
#pragma unroll
    for (int a = 0; a < 2; ++a)
#pragma unroll
        for (int b = 0; b < 2; ++b)
#pragma unroll
            for (int m = 0; m < 4; ++m)
#pragma unroll
                for (int n = 0; n < 2; ++n) acc[a][b][m][n] = (f32x4){0.f, 0.f, 0.f, 0.f};
    s16x8 At[4][2], B0[2][2], B1[2][2];
    const char* cA = PG8_UA(cur); const char* cB = PG8_UB(cur);
    S.a_ready(cur);
    if constexpr (SP2) {
        PG8_STAGE(PG8_SB(0, 0), cB, voffB); PG8_STAGE(PG8_SB(0, 1), cB + hstepB, voffB); PG8_STAGE(PG8_SA(0, 0), cA, voffA); PG8_STAGE(PG8_SA(0, 1), cA + hstepA, voffA);
        if (wr == 1) PG8_BAR;
        PG8_WAIT_V(2); PG8_BAR;
        PG8_STAGE(PG8_SB(1, 0), cB + kstep, voffB); PG8_STAGE(PG8_SA(1, 0), cA + kstep, voffA); PG8_STAGE(PG8_SB(1, 1), cB + hstepB + kstep, voffB);
        PG8_WAIT_V(6); PG8_BAR;
    } else {
        PG8_STAGE(PG8_SB(0, 0), cB, voffB); PG8_STAGE(PG8_SA(0, 0), cA, voffA); PG8_STAGE(PG8_SB(0, 1), cB + hstepB, voffB); PG8_STAGE(PG8_SA(0, 1), cA + hstepA, voffA);
        if (wr == 1) PG8_BAR;
        PG8_WAIT_V(4); PG8_BAR;
        PG8_STAGE(PG8_SB(1, 0), cB + kstep, voffB); PG8_STAGE(PG8_SA(1, 0), cA + kstep, voffA); PG8_STAGE(PG8_SB(1, 1), cB + hstepB + kstep, voffB);
        PG8_WAIT_V(6); PG8_BAR;
    }
    for (;;) {
        const bool has_next = S.next(ui + 1, nxt);
        const char* nA = has_next ? PG8_UA(nxt) : cA; const char* nB = has_next ? PG8_UB(nxt) : cB;
        for (int t = 0; t < nt; t += 2) {
            const bool last = (t == nt - 2);
            const char* a1 = cA + (size_t)(t + 1) * kstep;
            const char* a2 = last ? nA : cA + (size_t)(t + 2) * kstep; const char* b2 = last ? nB : cB + (size_t)(t + 2) * kstep;
            const char* a3 = a2 + kstep; const char* b3 = b2 + kstep;
            if (last && has_next) S.a_ready(nxt);
            if constexpr (SP2) {
            PG8_LDB(B0, 0, 0); PG8_LDB(B1, 0, 1); PG8_SCHED; PG8_LDA(At, 0, 0); PG8_STAGE(PG8_SA(1, 1), a1 + hstepA, voffA);
            PG8_WAIT_V(8); PG8_WAIT_L(0); PG8_BAR; PG8_MMA(0, 0, At, B0); PG8_MMA(0, 1, At, B1); PG8_BAR; PG8_SCHED;
            PG8_LDA(At, 0, 1); PG8_STAGE(PG8_SB(0, 0), b2, voffB); PG8_STAGE(PG8_SB(0, 1), b2 + hstepB, voffB); PG8_STAGE(PG8_SA(0, 0), a2, voffA);
            PG8_WAIT_V(8); PG8_WAIT_L(0); PG8_BAR; PG8_MMA(1, 0, At, B0); PG8_MMA(1, 1, At, B1); PG8_BAR; PG8_SCHED;
            PG8_LDB(B0, 1, 0); PG8_LDB(B1, 1, 1); PG8_SCHED; PG8_LDA(At, 1, 0); PG8_STAGE(PG8_SA(0, 1), a2 + hstepA, voffA);
            PG8_WAIT_V(8); PG8_WAIT_L(0); PG8_BAR; PG8_MMA(0, 0, At, B0); PG8_MMA(0, 1, At, B1); PG8_BAR; PG8_SCHED;
            PG8_LDA(At, 1, 1); PG8_STAGE(PG8_SB(1, 0), b3, voffB); PG8_STAGE(PG8_SB(1, 1), b3 + hstepB, voffB); PG8_STAGE(PG8_SA(1, 0), a3, voffA);
            PG8_WAIT_V(8); PG8_WAIT_L(0); PG8_BAR; PG8_MMA(1, 0, At, B0); PG8_MMA(1, 1, At, B1); PG8_BAR; PG8_SCHED;
            } else {
            PG8_LDB(B0, 0, 0); PG8_SCHED; PG8_LDA(At, 0, 0); PG8_STAGE(PG8_SA(1, 1), a1 + hstepA, voffA);
            PG8_WAIT_L(8); PG8_BAR; PG8_WAIT_L(0); PG8_MMA(0, 0, At, B0); PG8_BAR; PG8_SCHED;
            PG8_LDB(B1, 0, 1); PG8_STAGE(PG8_SB(0, 0), b2, voffB);
            PG8_BAR; PG8_WAIT_L(0); PG8_MMA(0, 1, At, B1); PG8_BAR;
            PG8_LDA(At, 0, 1); PG8_STAGE(PG8_SA(0, 0), a2, voffA);
            PG8_BAR; PG8_WAIT_L(0); PG8_MMA(1, 0, At, B0); PG8_BAR; PG8_SCHED;
            PG8_STAGE(PG8_SB(0, 1), b2 + hstepB, voffB);
            PG8_WAIT_V(6); PG8_BAR; PG8_MMA(1, 1, At, B1); PG8_BAR;
            PG8_LDB(B0, 1, 0); PG8_SCHED; PG8_LDA(At, 1, 0); PG8_STAGE(PG8_SA(0, 1), a2 + hstepA, voffA);
            PG8_WAIT_L(8); PG8_BAR; PG8_WAIT_L(0); PG8_MMA(0, 0, At, B0); PG8_BAR; PG8_SCHED;
            PG8_LDB(B1, 1, 1); PG8_STAGE(PG8_SB(1, 0), b3, voffB);
            PG8_BAR; PG8_WAIT_L(0); PG8_MMA(0, 1, At, B1); PG8_BAR;
            PG8_LDA(At, 1, 1); PG8_STAGE(PG8_SA(1, 0), a3, voffA);
            PG8_BAR; PG8_WAIT_L(0); PG8_MMA(1, 0, At, B0); PG8_BAR; PG8_SCHED;
            PG8_STAGE(PG8_SB(1, 1), b3 + hstepB, voffB);
            PG8_WAIT_V(6); PG8_BAR; PG8_MMA(1, 1, At, B1); PG8_BAR;
            }
        }
        if constexpr (ALIGN_EPI) { if (wr == 0) PG8_BAR; }
        if constexpr (!Epi::AFTER_DRAIN) { E(acc, cur, wr, wc, fr, fq); S.done(cur); }
        if (!has_next) break;
#pragma unroll
        for (int a = 0; a < 2; ++a)
#pragma unroll
            for (int b = 0; b < 2; ++b)
#pragma unroll
                for (int m = 0; m < 4; ++m)
#pragma unroll
                    for (int n = 0; n < 2; ++n) acc[a][b][m][n] = (f32x4){0.f, 0.f, 0.f, 0.f};
        cur = nxt; cA = nA; cB = nB; ++ui;
        if constexpr (ALIGN_EPI) { if (wr == 1) PG8_BAR; }
    }
    PG8_WAIT_V(0);
    if constexpr (!ALIGN_EPI) { if (wr == 0) PG8_BAR; }
    PG8_BAR;
    if constexpr (Epi::AFTER_DRAIN) { E.fused(acc, cur, wr, wc, fr, fq, lds, wid, lane); S.done(cur); }
#undef PG8_SA
#undef PG8_SB
#undef PG8_STAGE
#undef PG8_LDA
#undef PG8_LDB
#undef PG8_MMA
#undef PG8_WAIT_V
#undef PG8_WAIT_L
#undef PG8_BAR
#undef PG8_SCHED
}
#undef PG8_UA
#undef PG8_UB
}

using pg8::h16; using pg8::h16x8; using pg8::h16x4; using pg8::s16x8; using pg8::f32x4; using pg8::u32x4; using pg8::u32x2; using pg8::pk_h2;
#define LAS __attribute__((address_space(3)))
constexpr int NWAVES = 8, NTHR = 512;
constexpr int BATCH = 2, SEQ = 8192, D = 1024, M = BATCH * SEQ, DEPTH = 2, FF = 2816, DIN = 6312, NMEM = 256;
constexpr float EPS = 1e-6f;
constexpr int PW = 2560, P_POOL = 0, P_QLAT = 256, P_CKV = 768, P_IQ = 896, P_IK = 1152, P_IW = 1184, P_SBQ = 1216, P_SBK = 1472, P_SBV = 1728, P_SWQ = 1984, P_SWK = 2240, P_SWV = 2368;
constexpr int WI_POOL = 0, WI_DQ = 256, WI_CKV = 512, WI_IQ = 640, WI_IK = 896, WI_IW = 928, WI_SBQ = 936, WI_SBK = 1192, WI_SBV = 1448, WI_SWQ = 1704, WI_SWK = 1960, WI_SWV = 2088, WI_GATE = 2216;
constexpr int BRW = 1280, BR_A = 0, BR_C = 256, BR_D = 512, BR_B = 768;
enum { I_X = 0, I_MEM, I_F1PRE, I_F1UP, I_F1DN, I_F1POST, I_MIXPRE, I_WIN, I_POOLW, I_POOLS, I_KVN, I_WUK, I_WUV, I_SINK, I_WBR, I_WOUT, I_MIXPOST, I_XPRE, I_MEMN, I_XWQ, I_XWKV, I_XWO, I_XPOST, I_F2PRE, I_F2UP, I_F2DN, I_F2POST, N_IN };

constexpr size_t MiB = 1u << 20;
constexpr size_t WS_CTL = 0, CTL_BYTES = 1 * MiB;
constexpr size_t CTL_CSS = 256 * 1024;
constexpr size_t WS_W = 1 * MiB;
constexpr size_t W_UP1 = 0, W_DN1 = W_UP1 + (size_t)2 * FF * D * 2, W_P = W_DN1 + (size_t)D * FF * 2, W_G = W_P + (size_t)PW * D * 2, W_Y1 = W_G + (size_t)4096 * D * 2,
                 W_YB = W_Y1 + (size_t)3072 * 256 * 2, W_O = W_YB + (size_t)1024 * 512 * 2, W_XQ = W_O + (size_t)D * D * 2, W_XKV = W_XQ + (size_t)256 * D * 2, W_XO = W_XKV + (size_t)512 * D * 2,
                 W_UP2 = W_XO + (size_t)D * 256 * 2, W_DN2 = W_UP2 + (size_t)2 * FF * D * 2, W_END = W_DN2 + (size_t)D * FF * 2;
static_assert(W_END <= 53 * MiB, "weights region");
constexpr size_t WS_XN = 54 * MiB;
constexpr size_t WS_BIG = 86 * MiB;
constexpr size_t WS_BR = 214 * MiB;
constexpr size_t WS_MEMN = 254 * MiB;
constexpr size_t WS_XKV = 255 * MiB;
constexpr size_t WS_END = 256 * MiB;
constexpr size_t BIG_Q = 64 * MiB, BIG_AO = 72 * MiB;

constexpr int LDS_BYTES = 147456;

struct Args { const float* in[N_IN]; float* out; unsigned char* ws; int ph_lo, ph_hi; };
static_assert(sizeof(Args) == N_IN * 8 + 8 + 8 + 8, "no padding");
static_assert(sizeof(pg8::Gemm) == 40 && sizeof(pg8::EpiF16) == 40, "no padding");

__device__ __forceinline__ float wave_sum(float v) {
#pragma unroll
    for (int o = 1; o < 64; o <<= 1) v += __shfl_xor(v, o);
    return v;
}
__device__ __forceinline__ float wave_max(float v) {
#pragma unroll
    for (int o = 1; o < 64; o <<= 1) v = fmaxf(v, __shfl_xor(v, o));
    return v;
}
#define LDS_WAIT() asm volatile("s_waitcnt lgkmcnt(0)" ::: "memory")
__device__ __forceinline__ void ld8h(const h16* p, float* o) { const h16x8 v = *(const h16x8*)p;
#pragma unroll
    for (int i = 0; i < 8; ++i) o[i] = (float)v[i]; }

__device__ __forceinline__ void srcmap(int mode, int n, int& col, float& scale) {
    scale = 1.f; col = n;
    if (mode == 1) { const int pn = n >> 8, bj = (n >> 7) & 1, cl = n & 127; col = bj * FF + pn * 128 + cl; }
    else if (mode == 2) {
        if (n < P_IQ) col = WI_CKV + (n - P_CKV);
        else if (n < P_IK) col = WI_IQ + (n - P_IQ);
        else if (n < P_IW) col = WI_IK + (n - P_IK);
        else if (n < P_IW + 8) col = WI_IW + (n - P_IW);
        else if (n < P_SBQ) col = -1;
        else if (n < P_SBK) { col = WI_SBQ + (n - P_SBQ); scale = 0.125f; }
        else if (n < P_SBV) col = WI_SBK + (n - P_SBK);
        else if (n < P_SWQ) col = WI_SBV + (n - P_SBV);
        else if (n < P_SWK) { col = WI_SWQ + (n - P_SWQ); scale = 0.125f; }
        else if (n < P_SWV) col = WI_SWK + (n - P_SWK);
        else if (n < P_SWV + 128) col = WI_SWV + (n - P_SWV);
        else col = -1;
    } else if (mode == 3) { const int pn = n >> 8, c = n & 255, bj = c >> 7, wc = (c >> 5) & 3, nn = (c >> 4) & 1, fq = (c >> 2) & 3, e = c & 3;
        col = WI_GATE + (bj + 2 * nn) * 1024 + pn * 64 + wc * 16 + fq * 4 + e; }
    else if (mode == 4) { scale = 0.125f; }
}
__device__ __forceinline__ void tr_item(const float* W, int ldw, int K, h16* WT, int mode, int n0, int k0, LAS float* scr, int lane) {
    int col; float scale; srcmap(mode, n0 + (lane & 31), col, scale);
#pragma unroll 8
    for (int i = 0; i < 32; ++i) { const int kk = 2 * i + (lane >> 5); scr[kk * 33 + (lane & 31)] = col >= 0 ? W[(size_t)(k0 + kk) * ldw + col] * scale : 0.f; }
    LDS_WAIT(); asm volatile("" ::: "memory");
    const int c = lane & 7;
#pragma unroll
    for (int j = 0; j < 4; ++j) { const int n = (lane >> 3) + 8 * j; const LAS float* s = scr + (8 * c) * 33 + n;
        u32x4 o; o.x = pk_h2(s[0 * 33], s[1 * 33]); o.y = pk_h2(s[2 * 33], s[3 * 33]); o.z = pk_h2(s[4 * 33], s[5 * 33]); o.w = pk_h2(s[6 * 33], s[7 * 33]);
        *(u32x4*)(WT + (size_t)(n0 + n) * K + k0 + 8 * c) = o; }
    LDS_WAIT(); asm volatile("" ::: "memory");
}
__device__ __forceinline__ void rms_row_f16(const float* xrow, const float* g, h16* orow, int lane) {
    f32x4 v[4]; float s = 0.f;
#pragma unroll
    for (int j = 0; j < 4; ++j) { v[j] = *(const f32x4*)(xrow + j * 256 + lane * 4); s += (v[j].x * v[j].x + v[j].y * v[j].y) + (v[j].z * v[j].z + v[j].w * v[j].w); }
    const float rstd = 1.0f / sqrtf(wave_sum(s) * (1.f / D) + EPS);
#pragma unroll
    for (int j = 0; j < 4; ++j) { const f32x4 gv = *(const f32x4*)(g + j * 256 + lane * 4); const f32x4 o = v[j] * rstd * gv;
        u32x2 w; w.x = pk_h2(o.x, o.y); w.y = pk_h2(o.z, o.w); *(u32x2*)(orow + j * 256 + lane * 4) = w; }
}

struct Ctx {
    LAS unsigned char* lds;
    int tid, lane, wave, G, bid;
    __device__ __forceinline__ void init(LAS unsigned char* l) { lds = l; tid = threadIdx.x; lane = tid & 63; wave = __builtin_amdgcn_readfirstlane(tid >> 6); G = gridDim.x; bid = blockIdx.x; }
};
#define INP(i, l, per_layer) (args.in[i] + (size_t)(l) * (per_layer))
#define WPTR(off) ((h16*)(args.ws + WS_W + (off)))

__device__ __forceinline__ void prologue(const Ctx& C, const Args& args, int l) {
    LAS float* scr = (LAS float*)(C.lds + C.wave * 16384);
    const int gw = C.bid * NWAVES + C.wave, NGW = C.G * NWAVES;
    const float* win = INP(I_WIN, l, (size_t)D * DIN);
    const float* wbr = INP(I_WBR, l, (size_t)4 * 256 * D);
    int base = 0;
#define CONV(Wp, LDW, KK, N0, NROWS, MODE, WTp) do { const float* W_ = (Wp); h16* WT_ = (WTp); const int nkb = (KK) / 64, nit = ((NROWS) / 32) * nkb; \
        int it = gw - (base % NGW); if (it < 0) it += NGW; \
        for (; it < nit; it += NGW) { const int nb = it / nkb, kb = it % nkb; tr_item(W_, (LDW), (KK), WT_, (MODE), (N0) + nb * 32, kb * 64, scr, C.lane); } \
        base += nit; } while (0)
    CONV(INP(I_F1UP, l, (size_t)D * 2 * FF), 2 * FF, D, 0, 2 * FF, 1, WPTR(W_UP1));
    CONV(INP(I_F1DN, l, (size_t)FF * D), D, FF, 0, D, 0, WPTR(W_DN1));
    CONV(win, DIN, D, P_CKV, PW - P_CKV, 2, WPTR(W_P));
    CONV(win, DIN, D, 0, 4096, 3, WPTR(W_G));
    CONV(wbr + (size_t)0 * 256 * D, D, 256, 0, 1024, 0, WPTR(W_Y1));
    CONV(wbr + (size_t)2 * 256 * D, D, 256, 0, 1024, 0, WPTR(W_Y1) + (size_t)1024 * 256);
    CONV(wbr + (size_t)3 * 256 * D, D, 256, 0, 1024, 0, WPTR(W_Y1) + (size_t)2048 * 256);
    CONV(INP(I_WOUT, l, (size_t)D * D), D, D, 0, D, 0, WPTR(W_O));
    CONV(INP(I_XWQ, l, (size_t)D * 256), 256, D, 0, 256, 4, WPTR(W_XQ));
    CONV(INP(I_XWKV, l, (size_t)D * 512), 512, D, 0, 512, 0, WPTR(W_XKV));
    CONV(INP(I_XWO, l, (size_t)256 * D), D, 256, 0, D, 0, WPTR(W_XO));
    CONV(INP(I_F2UP, l, (size_t)D * 2 * FF), 2 * FF, D, 0, 2 * FF, 1, WPTR(W_UP2));
    CONV(INP(I_F2DN, l, (size_t)FF * D), D, FF, 0, D, 0, WPTR(W_DN2));
#undef CONV
    const int vt0 = C.bid * NTHR + C.tid, VT = C.G * NTHR;
    const float* poolw = INP(I_POOLW, l, 4 * 64 * 64); const float* pools = INP(I_POOLS, l, 256);
    const float* kvn = INP(I_KVN, l, 128); const float* wuk = INP(I_WUK, l, 128 * 4 * 64); const float* wuv = INP(I_WUV, l, 128 * 4 * 64);
    h16* WP = WPTR(W_P);
    for (int idx = vt0; idx < 256 * D; idx += VT) {
        const int k = idx & (D - 1), n = idx >> 10, g = n >> 6, d = n & 63; const float* wr = win + (size_t)k * DIN + WI_POOL + g * 64; const float* pw = poolw + g * 4096 + d;
        float a = 0.f;
#pragma unroll 8
        for (int c = 0; c < 64; ++c) a += wr[c] * pw[c * 64];
        WP[(size_t)(P_POOL + n) * D + k] = (h16)(a * pools[n]);
    }
    for (int idx = vt0; idx < 512 * D; idx += VT) {
        const int k = idx & (D - 1), n = idx >> 10, h = n >> 7, r = n & 127; const float* wr = win + (size_t)k * DIN + WI_DQ + h * 64; const float* uk = wuk + (r * 4 + h) * 64;
        float a = 0.f;
#pragma unroll 8
        for (int d = 0; d < 64; ++d) a += wr[d] * uk[d];
        WP[(size_t)(P_QLAT + n) * D + k] = (h16)(a * kvn[r] * 0.125f);
    }
    h16* WYB = WPTR(W_YB); const float* wb1 = wbr + (size_t)1 * 256 * D;
    for (int idx = vt0; idx < 512 * D; idx += VT) {
        const int kk = idx & 511, d = idx >> 9, h = kk >> 7, r = kk & 127; const float* uv = wuv + (r * 4 + h) * 64; const float* wb = wb1 + (size_t)(h * 64) * D + d;
        float a = 0.f;
#pragma unroll 8
        for (int e = 0; e < 64; ++e) a += uv[e] * wb[(size_t)e * D];
        WYB[(size_t)d * 512 + kk] = (h16)(a * kvn[r]);
    }
    const float* memg = INP(I_MEMN, l, D); h16* MEMN = (h16*)(args.ws + WS_MEMN);
    for (int r = gw; r < BATCH * NMEM; r += NGW) rms_row_f16(args.in[I_MEM] + (size_t)r * D, memg, MEMN + (size_t)r * D, C.lane);
    if (l == 0) { const float* g1 = args.in[I_F1PRE]; h16* XN = (h16*)(args.ws + WS_XN);
        for (int r = gw; r < M; r += NGW) rms_row_f16(args.in[I_X] + (size_t)r * D, g1, XN + (size_t)r * D, C.lane); }
}

__device__ __forceinline__ void norm_phase(const Ctx& C, const h16* T, const float* xin, float* xout, const float* gpost, float cres, const float* gnext, h16* XN) {
    const int gw = C.bid * NWAVES + C.wave, NGW = C.G * NWAVES, lane = C.lane;
    for (int m = gw; m < M; m += NGW) {
        f32x4 y[4]; float s = 0.f;
#pragma unroll
        for (int j = 0; j < 4; ++j) { const h16x4 t = *(const h16x4*)(T + (size_t)m * D + j * 256 + lane * 4); y[j] = (f32x4){(float)t[0], (float)t[1], (float)t[2], (float)t[3]};
            s += (y[j].x * y[j].x + y[j].y * y[j].y) + (y[j].z * y[j].z + y[j].w * y[j].w); }
        const float rstd = cres / sqrtf(wave_sum(s) * (1.f / D) + EPS);
        float s2 = 0.f;
#pragma unroll
        for (int j = 0; j < 4; ++j) { const f32x4 gv = *(const f32x4*)(gpost + j * 256 + lane * 4); const f32x4 xv = *(const f32x4*)(xin + (size_t)m * D + j * 256 + lane * 4);
            y[j] = xv + y[j] * rstd * gv; *(f32x4*)(xout + (size_t)m * D + j * 256 + lane * 4) = y[j];
            s2 += (y[j].x * y[j].x + y[j].y * y[j].y) + (y[j].z * y[j].z + y[j].w * y[j].w); }
        if (gnext != nullptr) { const float r2 = 1.0f / sqrtf(wave_sum(s2) * (1.f / D) + EPS);
#pragma unroll
            for (int j = 0; j < 4; ++j) { const f32x4 gv = *(const f32x4*)(gnext + j * 256 + lane * 4); const f32x4 o = y[j] * r2 * gv;
                u32x2 w; w.x = pk_h2(o.x, o.y); w.y = pk_h2(o.z, o.w); *(u32x2*)(XN + (size_t)m * D + j * 256 + lane * 4) = w; } }
    }
}

__device__ __forceinline__ void mix_pool(const Ctx& C, const h16* P, h16* BR) {
    const int vt0 = C.bid * NTHR + C.tid, VT = C.G * NTHR;
    for (int idx = vt0; idx < M * 256; idx += VT) {
        const int m = idx >> 8, ch = idx & 255, g = ch >> 6, w = 2 << g, t = m & (SEQ - 1), cnt = (t + 1 < w) ? t + 1 : w;
        float s = 0.f; for (int j = 0; j < cnt; ++j) s += (float)P[(size_t)(m - j) * PW + P_POOL + ch];
        const float self = (float)P[(size_t)m * PW + P_POOL + ch];
        BR[(size_t)m * BRW + BR_A + ch] = (h16)(s / (float)cnt - self);
    }
}
__device__ __forceinline__ void mix_swa(const Ctx& C, const h16* P, h16* BR, const float* sinks) {
    const int gw = C.bid * NWAVES + C.wave, NGW = C.G * NWAVES, lane = C.lane;
    for (int wv = gw; wv < (M / 64) * 4; wv += NGW) {
        const int hq = wv & 3, m = (wv >> 2) * 64 + lane, t = m & (SEQ - 1), kvh = hq >> 1;
        float q[64], o[64];
#pragma unroll
        for (int i = 0; i < 8; ++i) ld8h(P + (size_t)m * PW + P_SWQ + hq * 64 + i * 8, q + i * 8);
#pragma unroll
        for (int i = 0; i < 64; ++i) o[i] = 0.f;
        float mr = sinks[hq], l = 1.f;
        const int nk = (t + 1 < 128) ? t + 1 : 128;
        for (int j = 0; j < nk; ++j) {
            const h16* kr = P + (size_t)(m - j) * PW + P_SWK + kvh * 64; const h16* vr = P + (size_t)(m - j) * PW + P_SWV + kvh * 64;
            float s = 0.f;
#pragma unroll
            for (int i = 0; i < 8; ++i) { float kv[8]; ld8h(kr + i * 8, kv);
#pragma unroll
                for (int e = 0; e < 8; ++e) s += q[i * 8 + e] * kv[e]; }
            const float mn = fmaxf(mr, s), sc = __expf(mr - mn), p = __expf(s - mn);
            l = l * sc + p; mr = mn;
#pragma unroll
            for (int i = 0; i < 8; ++i) { float vv[8]; ld8h(vr + i * 8, vv);
#pragma unroll
                for (int e = 0; e < 8; ++e) o[i * 8 + e] = o[i * 8 + e] * sc + p * vv[e]; }
        }
        const float inv = 1.0f / l;
#pragma unroll
        for (int i = 0; i < 8; ++i) { u32x4 w; w.x = pk_h2(o[i * 8] * inv, o[i * 8 + 1] * inv); w.y = pk_h2(o[i * 8 + 2] * inv, o[i * 8 + 3] * inv); w.z = pk_h2(o[i * 8 + 4] * inv, o[i * 8 + 5] * inv); w.w = pk_h2(o[i * 8 + 6] * inv, o[i * 8 + 7] * inv);
            *(u32x4*)(BR + (size_t)m * BRW + BR_D + hq * 64 + i * 8) = w; }
    }
}
__device__ __forceinline__ void mix_sb(const Ctx& C, const h16* P, h16* BR) {
    const int gw = C.bid * NWAVES + C.wave, NGW = C.G * NWAVES, lane = C.lane;
    for (int wv = gw; wv < (M / 64) * 4; wv += NGW) {
        const int h = wv & 3, m = (wv >> 2) * 64 + lane, t = m & (SEQ - 1);
        float q[64], o[64];
#pragma unroll
        for (int i = 0; i < 8; ++i) ld8h(P + (size_t)m * PW + P_SBQ + h * 64 + i * 8, q + i * 8);
#pragma unroll
        for (int i = 0; i < 64; ++i) o[i] = 0.f;
        float carry = 0.f;
        for (int j = 1; j <= t; ++j) {
            const h16* kr = P + (size_t)(m - j) * PW + P_SBK + h * 64; const h16* vr = P + (size_t)(m - j) * PW + P_SBV + h * 64;
            float z = 0.f;
#pragma unroll
            for (int i = 0; i < 8; ++i) { float kv[8]; ld8h(kr + i * 8, kv);
#pragma unroll
                for (int e = 0; e < 8; ++e) z += q[i * 8 + e] * kv[e]; }
            const float sp = fmaxf(z, 0.f) + __logf(1.0f + __expf(-fabsf(z)));
            const float a = __expf(z - sp + carry);
            carry -= sp;
#pragma unroll
            for (int i = 0; i < 8; ++i) { float vv[8]; ld8h(vr + i * 8, vv);
#pragma unroll
                for (int e = 0; e < 8; ++e) o[i * 8 + e] += a * vv[e]; }
            if (carry < -80.f) break;
        }
#pragma unroll
        for (int i = 0; i < 8; ++i) { u32x4 w; w.x = pk_h2(o[i * 8], o[i * 8 + 1]); w.y = pk_h2(o[i * 8 + 2], o[i * 8 + 3]); w.z = pk_h2(o[i * 8 + 4], o[i * 8 + 5]); w.w = pk_h2(o[i * 8 + 6], o[i * 8 + 7]);
            *(u32x4*)(BR + (size_t)m * BRW + BR_C + h * 64 + i * 8) = w; }
    }
}
__device__ __forceinline__ void xattn_phase(const Ctx& C, const h16* Q, const h16* XKV, h16* AO) {
    const int gw = C.bid * NWAVES + C.wave, NGW = C.G * NWAVES, lane = C.lane;
    for (int wv = gw; wv < (M / 64) * 4; wv += NGW) {
        const int h = wv & 3, m = (wv >> 2) * 64 + lane, b = m >> 13;
        float q[64], o[64];
#pragma unroll
        for (int i = 0; i < 8; ++i) ld8h(Q + (size_t)m * 256 + h * 64 + i * 8, q + i * 8);
#pragma unroll
        for (int i = 0; i < 64; ++i) o[i] = 0.f;
        float mr = -1e30f, l = 0.f;
        for (int j = 0; j < NMEM; ++j) {
            const h16* kr = XKV + (size_t)(b * NMEM + j) * 512 + h * 64; const h16* vr = kr + 256;
            float s = 0.f;
#pragma unroll
            for (int i = 0; i < 8; ++i) { float kv[8]; ld8h(kr + i * 8, kv);
#pragma unroll
                for (int e = 0; e < 8; ++e) s += q[i * 8 + e] * kv[e]; }
            const float mn = fmaxf(mr, s), sc = __expf(mr - mn), p = __expf(s - mn);
            l = l * sc + p; mr = mn;
#pragma unroll
            for (int i = 0; i < 8; ++i) { float vv[8]; ld8h(vr + i * 8, vv);
#pragma unroll
                for (int e = 0; e < 8; ++e) o[i * 8 + e] = o[i * 8 + e] * sc + p * vv[e]; }
        }
        const float inv = 1.0f / l;
#pragma unroll
        for (int i = 0; i < 8; ++i) { u32x4 w; w.x = pk_h2(o[i * 8] * inv, o[i * 8 + 1] * inv); w.y = pk_h2(o[i * 8 + 2] * inv, o[i * 8 + 3] * inv); w.z = pk_h2(o[i * 8 + 4] * inv, o[i * 8 + 5] * inv); w.w = pk_h2(o[i * 8 + 6] * inv, o[i * 8 + 7] * inv);
            *(u32x4*)(AO + (size_t)m * 256 + h * 64 + i * 8) = w; }
    }
}

__device__ __forceinline__ unsigned fkey(float f) { const unsigned u = __float_as_uint(f); return (u & 0x80000000u) ? ~u : (u | 0x80000000u); }
constexpr int DL_SC = 0, DL_IQ = 32768, DL_W = 33792, DL_HIST = 33824, DL_MISC = 34848, DL_SEL = 34912, DL_QL = 35936, DL_SL = 37984, DL_RS = 42080, DL_WT = 43104;
__device__ __forceinline__ void mix_dsa(const Ctx& C, const h16* P, h16* BR, const float* css) {
    LAS float* sc = (LAS float*)(C.lds + DL_SC); LAS float* iq = (LAS float*)(C.lds + DL_IQ); LAS float* wq = (LAS float*)(C.lds + DL_W);
    LAS unsigned* hist = (LAS unsigned*)(C.lds + DL_HIST); LAS unsigned* misc = (LAS unsigned*)(C.lds + DL_MISC); LAS int* sel = (LAS int*)(C.lds + DL_SEL);
    LAS float* ql = (LAS float*)(C.lds + DL_QL); LAS float* sl = (LAS float*)(C.lds + DL_SL); LAS float* rs = (LAS float*)(C.lds + DL_RS); LAS unsigned* wtot = (LAS unsigned*)(C.lds + DL_WT);
    const int tid = C.tid, lane = C.lane, wave = C.wave;
    for (int m = C.bid; m < M; m += C.G) {
        const int b = m >> 13, t = m & (SEQ - 1), n = t + 1; const size_t base = (size_t)b * SEQ;
        __syncthreads();
        if (tid < 256) iq[tid] = (float)P[(size_t)m * PW + P_IQ + tid];
        if (tid < 8) wq[tid] = (float)P[(size_t)m * PW + P_IW + tid];
        ql[tid] = (float)P[(size_t)m * PW + P_QLAT + tid];
        __syncthreads();
        int cnt;
        if (n <= 256) { if (tid < n) sel[tid] = tid; cnt = n; }
        else {
            for (int s = tid; s < n; s += NTHR) {
                float ik[32];
#pragma unroll
                for (int i = 0; i < 4; ++i) ld8h(P + (base + s) * PW + P_IK + i * 8, ik + i * 8);
                float score = 0.f;
#pragma unroll
                for (int h = 0; h < 8; ++h) { float d = 0.f;
#pragma unroll
                    for (int e = 0; e < 32; ++e) d += iq[h * 32 + e] * ik[e];
                    score += wq[h] * fmaxf(d, 0.f); }
                sc[s] = score + 0.0f;
            }
            __syncthreads();
            unsigned prefix = 0u, mask = 0u, need = 256u, ceq = 0u;
#pragma unroll 1
            for (int pass = 0; pass < 4; ++pass) {
                const int shift = 24 - 8 * pass;
                if (tid < 256) hist[tid] = 0u;
                __syncthreads();
                for (int s = tid; s < n; s += NTHR) { const unsigned u = fkey(sc[s]); if ((u & mask) == prefix) atomicAdd((unsigned*)&hist[(u >> shift) & 255u], 1u); }
                __syncthreads();
                if (wave == 0) {
                    const unsigned c0 = hist[4 * lane], c1 = hist[4 * lane + 1], c2 = hist[4 * lane + 2], c3 = hist[4 * lane + 3], tot = c0 + c1 + c2 + c3;
                    unsigned incl = tot;
#pragma unroll
                    for (int o = 1; o < 64; o <<= 1) { const unsigned v = __shfl_down(incl, o); if (lane + o < 64) incl += v; }
                    unsigned cum = incl - tot;
                    if (cum < need && cum + c3 >= need) { misc[0] = 4 * lane + 3; misc[1] = need - cum; misc[2] = c3; } cum += c3;
                    if (cum < need && cum + c2 >= need) { misc[0] = 4 * lane + 2; misc[1] = need - cum; misc[2] = c2; } cum += c2;
                    if (cum < need && cum + c1 >= need) { misc[0] = 4 * lane + 1; misc[1] = need - cum; misc[2] = c1; } cum += c1;
                    if (cum < need && cum + c0 >= need) { misc[0] = 4 * lane + 0; misc[1] = need - cum; misc[2] = c0; }
                }
                __syncthreads();
                const unsigned digit = misc[0]; need = misc[1]; ceq = misc[2];
                prefix |= digit << shift; mask |= 255u << shift;
            }
            if (tid == 0) misc[3] = 0u;
            __syncthreads();
            if (ceq == need) {
                for (int s = tid; s < n; s += NTHR) { const unsigned u = fkey(sc[s]); if (u >= prefix) { const unsigned p = atomicAdd((unsigned*)&misc[3], 1u); sel[p] = s; } }
            } else {
                unsigned eq_base = 0u;
                for (int c0 = 0; c0 < n; c0 += NTHR) {
                    const int s = c0 + tid; const unsigned u = s < n ? fkey(sc[s]) : 0u; const bool gt = s < n && u > prefix, eq = s < n && u == prefix;
                    const unsigned long long bm = __ballot(eq); const unsigned wrk = __popcll(bm & ((1ull << lane) - 1ull)); if (lane == 0) wtot[wave] = (unsigned)__popcll(bm);
                    __syncthreads();
                    unsigned woff = 0u, tot = 0u;
#pragma unroll
                    for (int w = 0; w < NWAVES; ++w) { const unsigned v = wtot[w]; if (w < wave) woff += v; tot += v; }
                    if (gt || (eq && eq_base + woff + wrk < need)) { const unsigned p = atomicAdd((unsigned*)&misc[3], 1u); sel[p] = s; }
                    eq_base += tot;
                    __syncthreads();
                }
            }
            cnt = 256;
        }
        __syncthreads();
        { const int j = tid & 255, hp = tid >> 8;
          if (j < cnt) { const int key = sel[j]; const h16* cr = P + (base + key) * PW + P_CKV; const float r = 1.0f / sqrtf(css[base + key] * (1.f / 128.f) + EPS);
              float d0 = 0.f, d1 = 0.f;
#pragma unroll
              for (int i = 0; i < 16; ++i) { float cv[8]; ld8h(cr + i * 8, cv);
#pragma unroll
                  for (int e = 0; e < 8; ++e) { d0 += ql[(2 * hp) * 128 + i * 8 + e] * cv[e]; d1 += ql[(2 * hp + 1) * 128 + i * 8 + e] * cv[e]; } }
              sl[(2 * hp) * 256 + j] = d0 * r; sl[(2 * hp + 1) * 256 + j] = d1 * r; if (hp == 0) rs[j] = r; } }
        __syncthreads();
        if (wave < 4) {
            float v[4]; float mx = -1e30f;
#pragma unroll
            for (int i = 0; i < 4; ++i) { const int j = lane + 64 * i; v[i] = j < cnt ? sl[wave * 256 + j] : -1e30f; mx = fmaxf(mx, v[i]); }
            mx = wave_max(mx); float sm = 0.f;
#pragma unroll
            for (int i = 0; i < 4; ++i) { const int j = lane + 64 * i; v[i] = j < cnt ? __expf(v[i] - mx) : 0.f; sm += v[i]; }
            sm = wave_sum(sm); const float inv = 1.0f / sm;
#pragma unroll
            for (int i = 0; i < 4; ++i) { const int j = lane + 64 * i; if (j < cnt) sl[wave * 256 + j] = v[i] * inv * rs[j]; }
        }
        __syncthreads();
        { const int h = tid >> 7, r = tid & 127; float a = 0.f;
          for (int j = 0; j < cnt; ++j) a += sl[h * 256 + j] * (float)P[(base + sel[j]) * PW + P_CKV + r];
          BR[(size_t)m * BRW + BR_B + h * 128 + r] = (h16)a; }
    }
    __syncthreads();
}

#define KLDS extern __shared__ __attribute__((aligned(16))) unsigned char lds_raw[]; Ctx C; C.init((LAS unsigned char*)lds_raw)
__global__ void __launch_bounds__(NTHR, 2) k_prologue(Args args, int l) { KLDS; prologue(C, args, l); }
__global__ void __launch_bounds__(NTHR, 2) k_gemm_swiglu(const h16* A, const h16* Bt, h16* H) {
    KLDS; pg8::Gemm g{A, Bt, D, D, D, 1 << 20, 0, 0}; pg8::StaticOrder S; S.init(M, 2 * FF, C.G, C.bid); pg8::EpiSwiglu E{H, FF};
    pg8::gemm_phase<pg8::EpiSwiglu, pg8::StaticOrder, true, true>(C.lds, g, S, E);
}
__global__ void __launch_bounds__(NTHR, 2) k_gemm_gate(const h16* A, const h16* Bt, const h16* Y, h16* MG) {
    KLDS; pg8::Gemm g{A, Bt, D, D, D, 1 << 20, 0, 0}; pg8::StaticOrder S; S.init(M, 4096, C.G, C.bid); pg8::EpiGate E{Y, MG};
    pg8::gemm_phase<pg8::EpiGate, pg8::StaticOrder, true, true>(C.lds, g, S, E);
}
__global__ void __launch_bounds__(NTHR, 2) k_gemm_f16(pg8::Gemm g, pg8::EpiF16 E, int Mr, int N) {
    KLDS; pg8::StaticOrder S; S.init(Mr, N, C.G, C.bid);
    pg8::gemm_phase<pg8::EpiF16, pg8::StaticOrder, true, true>(C.lds, g, S, E);
}
__global__ void __launch_bounds__(NTHR, 2) k_norm(const h16* T, const float* xin, float* xout, const float* gpost, float cres, const float* gnext, h16* XN) { KLDS; norm_phase(C, T, xin, xout, gpost, cres, gnext, XN); }
__global__ void __launch_bounds__(NTHR, 2) k_mix_a(const h16* P, h16* BR, const float* sinks) { KLDS; mix_pool(C, P, BR); mix_swa(C, P, BR, sinks); mix_sb(C, P, BR); }
__global__ void __launch_bounds__(NTHR, 2) k_mix_dsa(const h16* P, h16* BR, const float* css) { KLDS; mix_dsa(C, P, BR, css); }
__global__ void __launch_bounds__(NTHR, 2) k_xattn(const h16* Q, const h16* XKV, h16* AO) { KLDS; xattn_phase(C, Q, XKV, AO); }

extern "C" void kernel_launch(void* const* d_in, const int* in_sizes, int n_in, void* d_out, int out_size, void* d_ws, size_t ws_size, hipStream_t stream) {
    static int grid = 0;
    if (grid == 0) {
        if (n_in != N_IN || in_sizes[0] != M * D || out_size != M * D || ws_size < WS_END) { fprintf(stderr, "kernel_launch: unexpected shapes (n_in %d, in0 %d, out %d, ws %zu)\n", n_in, n_in > 0 ? in_sizes[0] : -1, out_size, ws_size); grid = -1; return; }
        int dev = 0, cus = 0;
        if (hipGetDevice(&dev) != hipSuccess || hipDeviceGetAttribute(&cus, hipDeviceAttributeMultiprocessorCount, dev) != hipSuccess) { grid = -1; return; }
        bool ok = true;
        ok &= hipFuncSetAttribute((const void*)k_prologue, hipFuncAttributeMaxDynamicSharedMemorySize, LDS_BYTES) == hipSuccess;
        ok &= hipFuncSetAttribute((const void*)k_gemm_swiglu, hipFuncAttributeMaxDynamicSharedMemorySize, LDS_BYTES) == hipSuccess;
        ok &= hipFuncSetAttribute((const void*)k_gemm_gate, hipFuncAttributeMaxDynamicSharedMemorySize, LDS_BYTES) == hipSuccess;
        ok &= hipFuncSetAttribute((const void*)k_gemm_f16, hipFuncAttributeMaxDynamicSharedMemorySize, LDS_BYTES) == hipSuccess;
        ok &= hipFuncSetAttribute((const void*)k_norm, hipFuncAttributeMaxDynamicSharedMemorySize, LDS_BYTES) == hipSuccess;
        ok &= hipFuncSetAttribute((const void*)k_mix_a, hipFuncAttributeMaxDynamicSharedMemorySize, LDS_BYTES) == hipSuccess;
        ok &= hipFuncSetAttribute((const void*)k_mix_dsa, hipFuncAttributeMaxDynamicSharedMemorySize, LDS_BYTES) == hipSuccess;
        ok &= hipFuncSetAttribute((const void*)k_xattn, hipFuncAttributeMaxDynamicSharedMemorySize, LDS_BYTES) == hipSuccess;
        if (!ok) { fprintf(stderr, "kernel_launch: hipFuncSetAttribute failed\n"); grid = -1; return; }
        (void)hipGetLastError();
        grid = cus;
    }
    if (grid < 0) return;
    (void)hipMemsetAsync((char*)d_ws + WS_CTL, 0, CTL_BYTES, stream);
    Args args{};
    for (int i = 0; i < N_IN; ++i) args.in[i] = (const float*)d_in[i];
    args.out = (float*)d_out; args.ws = (unsigned char*)d_ws;
    unsigned char* ws = (unsigned char*)d_ws; float* out = (float*)d_out;
    h16* XN = (h16*)(ws + WS_XN); h16* BIG = (h16*)(ws + WS_BIG); h16* BRb = (h16*)(ws + WS_BR);
    h16* Hb = BIG; h16* Pb = BIG; h16* Yb = BIG; h16* Qb = (h16*)(ws + WS_BIG + BIG_Q); h16* AOb = (h16*)(ws + WS_BIG + BIG_AO);
    h16* MEMN = (h16*)(ws + WS_MEMN); h16* XKV = (h16*)(ws + WS_XKV);
    const dim3 gd(grid), bd(NTHR);
#define LAUNCH(k, ...) hipLaunchKernelGGL(k, gd, bd, LDS_BYTES, stream, __VA_ARGS__)
    auto gemm_f16 = [&](const h16* A, int lda, int K, int agrp, int astep, const h16* Bt, int ldb, int Mr, int N, h16* O, int ldc, int gsz, int gb0, int gb1, int gb2, float* cssp, int css_pn) {
        pg8::Gemm g{A, Bt, lda, ldb, K, agrp, astep, 0}; pg8::EpiF16 E{O, cssp, ldc, gsz, gb0, gb1, gb2, css_pn}; LAUNCH(k_gemm_f16, g, E, Mr, N); };
    const int BIGN = 1 << 20;
    for (int l = 0; l < DEPTH; ++l) {
        float* css = (float*)(ws + WS_CTL + CTL_CSS) + (size_t)l * M;
        LAUNCH(k_prologue, args, l);
        LAUNCH(k_gemm_swiglu, (const h16*)XN, (const h16*)WPTR(W_UP1), Hb);
        gemm_f16(Hb, FF, FF, BIGN, 0, WPTR(W_DN1), FF, M, D, BRb, D, BIGN, 0, 0, 0, nullptr, -1);
        LAUNCH(k_norm, (const h16*)BRb, (const float*)(l == 0 ? args.in[I_X] : out), out, INP(I_F1POST, l, D), 0.5f, INP(I_MIXPRE, l, D), XN);
        gemm_f16(XN, D, D, BIGN, 0, WPTR(W_P), D, M, PW, Pb, PW, BIGN, 0, 0, 0, css, 3);
        gemm_f16(MEMN, D, D, BIGN, 0, WPTR(W_XKV), D, BATCH * NMEM, 512, XKV, 512, BIGN, 0, 0, 0, nullptr, -1);
        LAUNCH(k_mix_a, (const h16*)Pb, BRb, INP(I_SINK, l, 4));
        LAUNCH(k_mix_dsa, (const h16*)Pb, BRb, (const float*)css);
        gemm_f16(BRb, BRW, 256, 4, 256, WPTR(W_Y1), 256, M, 3072, Yb, 4096, 4, 0, 2048, 3072, nullptr, -1);
        gemm_f16(BRb + BR_B, BRW, 512, BIGN, 0, WPTR(W_YB), 512, M, 1024, Yb, 4096, 4, 1024, 0, 0, nullptr, -1);
        LAUNCH(k_gemm_gate, (const h16*)XN, (const h16*)WPTR(W_G), (const h16*)Yb, BRb);
        gemm_f16(BRb, D, D, BIGN, 0, WPTR(W_O), D, M, D, BIG, D, BIGN, 0, 0, 0, nullptr, -1);
        LAUNCH(k_norm, (const h16*)BIG, (const float*)out, out, INP(I_MIXPOST, l, D), 1.0f, INP(I_XPRE, l, D), XN);
        gemm_f16(XN, D, D, BIGN, 0, WPTR(W_XQ), D, M, 256, Qb, 256, BIGN, 0, 0, 0, nullptr, -1);
        LAUNCH(k_xattn, (const h16*)Qb, (const h16*)XKV, AOb);
        gemm_f16(AOb, 256, 256, BIGN, 0, WPTR(W_XO), 256, M, D, BRb, D, BIGN, 0, 0, 0, nullptr, -1);
        LAUNCH(k_norm, (const h16*)BRb, (const float*)out, out, INP(I_XPOST, l, D), 1.0f, INP(I_F2PRE, l, D), XN);
        LAUNCH(k_gemm_swiglu, (const h16*)XN, (const h16*)WPTR(W_UP2), Hb);
        gemm_f16(Hb, FF, FF, BIGN, 0, WPTR(W_DN2), FF, M, D, BRb, D, BIGN, 0, 0, 0, nullptr, -1);
        LAUNCH(k_norm, (const h16*)BRb, (const float*)out, out, INP(I_F2POST, l, D), 0.5f, (const float*)(l + 1 < DEPTH ? INP(I_F1PRE, l + 1, D) : nullptr), XN);
    }
}
```
